# Optimizing an MI355X kernel written in HIP

```python
import math
import jax, jax.numpy as jnp
from jax import lax
import numpy as np

D_MODEL = 1024
BATCH = 2
SEQ = 16384
DEPTH = 1
DEC_BATCH = 16
DEC_SEQ = 32
PAST_LEN = 1024

CHUNK = 64
Q_BLOCK = 128
HA = 4
DH = D_MODEL // 8
D_A = HA * DH
HB = 4
DK = D_MODEL // 16
DV = 2 * DK
D_QB = HB * 2 * DK
D_VB = HB * DV
CONV_W = 4
FF = 4 * D_MODEL
NUM_BUCKETS = 32
MAX_DISTANCE = 128
EPS = 1e-6
N_IN = 4 * D_A + 2 * HA + 2 * D_QB + D_VB + 2 * D_MODEL

kernel_name = "hybrid_mlstm_diffattn_streaming_step"


def rmsnorm(x, g):
    xf = x.astype(jnp.float32)
    y = xf * lax.rsqrt(jnp.mean(xf * xf, axis=-1, keepdims=True) + EPS)
    return (y * g.astype(jnp.float32)).astype(x.dtype)


def rel_bucket(rel_pos):
    half = NUM_BUCKETS // 2
    max_exact = half // 2
    n = jnp.abs(rel_pos)
    large = max_exact + (jnp.log(jnp.maximum(n, 1).astype(jnp.float32) / max_exact)
                         / math.log(MAX_DISTANCE / max_exact) * (half - max_exact)).astype(jnp.int32)
    large = jnp.minimum(large, half - 1)
    return jnp.where(rel_pos > 0, half, 0) + jnp.where(n < max_exact, n, large)


def causal_conv(x, buf, w, b):
    T = x.shape[1]
    xp = jnp.concatenate([buf.astype(x.dtype), x], axis=1)
    out = b + xp[:, 0:T] * w[0]
    for j in range(1, CONV_W):
        out = out + xp[:, j:j + T] * w[j]
    return out, xp[:, T:]


def mlstm_chunk(carry, xs):
    C, n, m = carry
    q, k, v, ig, lf = xs
    L = q.shape[2]
    b = jnp.cumsum(lf, axis=-1)
    a = b + m[..., None]
    causal = jnp.tril(jnp.ones((L, L), dtype=bool))
    dlog = jnp.where(causal, b[..., :, None] - b[..., None, :] + ig[..., None, :], -jnp.inf)
    m_t = jnp.maximum(a, jnp.max(dlog, axis=-1))
    w_inter = jnp.exp(a - m_t)
    s = jnp.exp(dlog - m_t[..., None]) * jnp.einsum('bhtd,bhsd->bhts', q, k)
    num = w_inter[..., None] * jnp.einsum('bhvd,bhtd->bhtv', C, q) + jnp.einsum('bhts,bhsv->bhtv', s, v)
    den = w_inter * jnp.einsum('bhd,bhtd->bht', n, q) + jnp.sum(s, axis=-1)
    h = num / jnp.maximum(jnp.abs(den), jnp.exp(-m_t))[..., None]
    g = b[..., -1]
    ls = g[..., None] - b + ig
    m_new = jnp.maximum(g + m, jnp.max(ls, axis=-1))
    decay = jnp.exp(g + m - m_new)
    ws = jnp.exp(ls - m_new[..., None])
    C_new = decay[..., None, None] * C + jnp.einsum('bhs,bhsv,bhsd->bhvd', ws, v, k)
    n_new = decay[..., None] * n + jnp.einsum('bhs,bhsd->bhd', ws, k)
    return (C_new, n_new, m_new), h


def mlstm(q, k, v, ig, lf, C, n, m):
    B, H, T, D = q.shape
    L = min(T, CHUNK)
    nc = T // L

    def chunks(t):
        return jnp.moveaxis(t.reshape(t.shape[:2] + (nc, L) + t.shape[3:]), 2, 0)

    (C, n, m), hs = lax.scan(mlstm_chunk, (C, n, m), (chunks(q), chunks(k), chunks(v), chunks(ig), chunks(lf)))
    h = jnp.moveaxis(hs, 0, 2).reshape(B, H, T, D)
    return h, C, n, m


def diff_attention(q, k, v, q_pos, k_pos, rel_bias, lam):
    B, T = q.shape[:2]
    qb = min(T, Q_BLOCK)
    nb = T // qb
    q_blocks = jnp.moveaxis(q.reshape((B, nb, qb) + q.shape[2:]), 1, 0)
    p_blocks = q_pos.reshape(nb, qb)
    scale = DK ** -0.5
    k_chunk = k_pos // CHUNK

    def block(args):
        qi, pi = args
        s = jnp.einsum('bqhcd,bshcd->bhcqs', qi, k).astype(jnp.float32) * scale
        bias = rel_bias[rel_bucket(k_pos[None, :] - pi[:, None])].astype(jnp.float32)
        s = s + jnp.transpose(bias, (2, 0, 1))[None, :, None]
        allowed = k_chunk[None, :] <= (pi // CHUNK)[:, None]
        p = jax.nn.softmax(jnp.where(allowed, s, -jnp.inf), axis=-1)
        a = p[:, :, 0] - lam * p[:, :, 1]
        return jnp.einsum('bhqs,bshd->bqhd', a.astype(v.dtype), v)

    out = lax.map(block, (q_blocks, p_blocks))
    return jnp.moveaxis(out, 0, 1).reshape((B, T) + v.shape[2:])


def trunk_layer(x, k_past, v_past, C0, n0, m0, conv0, rel_bias, g_pre_mix, g_post_mix, g_pre_ffn,
                g_post_ffn, w_in, b_in, conv_w, conv_b, g_head_a, w_pa, lambda_q1, lambda_k1,
                lambda_q2, lambda_k2, g_head_b, w_pb, w_out, w_ff1, w_ff2, lambda_init):
    f32 = jnp.float32
    B, T, _ = x.shape
    P = k_past.shape[1]
    u = rmsnorm(x, g_pre_mix)
    proj = u @ w_in + b_in
    sizes = (2 * D_A, D_A, D_A, HA, HA, D_QB, D_QB, D_VB, D_MODEL)
    points = []
    acc = 0
    for sz in sizes:
        acc += sz
        points.append(acc)
    qk_a, v_a, o_a, i_a, f_a, q_b, k_b, v_b, gate_a, gate_b = jnp.split(proj, points, axis=-1)

    qk_c, conv_new = causal_conv(qk_a, conv0, conv_w, conv_b)
    qk_c = jax.nn.silu(qk_c)

    def heads(t):
        return jnp.transpose(t.reshape(B, T, HA, DH), (0, 2, 1, 3)).astype(f32)

    q_m = heads(qk_c[..., :D_A])
    k_m = heads(qk_c[..., D_A:]) * (DH ** -0.5)
    v_m = heads(v_a)
    ig = jnp.transpose(i_a, (0, 2, 1)).astype(f32)
    lf = jax.nn.log_sigmoid(jnp.transpose(f_a, (0, 2, 1)).astype(f32))
    h, C_new, n_new, m_new = mlstm(q_m, k_m, v_m, ig, lf, C0.astype(f32), n0.astype(f32), m0.astype(f32))
    h = rmsnorm(jnp.transpose(h, (0, 2, 1, 3)), g_head_a)
    h_a = (h.reshape(B, T, D_A) * jax.nn.sigmoid(o_a.astype(f32))).astype(x.dtype)
    y_a = h_a @ w_pa

    qd = q_b.reshape(B, T, HB, 2, DK)
    kd = k_b.reshape(B, T, HB, 2, DK)
    vd = v_b.reshape(B, T, HB, DV)
    k_all = jnp.concatenate([k_past.astype(kd.dtype).reshape(B, P, HB, 2, DK), kd], axis=1)
    v_all = jnp.concatenate([v_past.astype(vd.dtype), vd], axis=1)
    lam = (jnp.exp(jnp.sum(lambda_q1.astype(f32) * lambda_k1.astype(f32)))
           - jnp.exp(jnp.sum(lambda_q2.astype(f32) * lambda_k2.astype(f32))) + lambda_init)
    q_pos = P + jnp.arange(T, dtype=jnp.int32)
    k_pos = jnp.arange(P + T, dtype=jnp.int32)
    o_b = diff_attention(qd, k_all, v_all, q_pos, k_pos, rel_bias, lam)
    o_b = rmsnorm(o_b, g_head_b) * (1.0 - lambda_init)
    y_b = o_b.reshape(B, T, D_VB) @ w_pb

    mix = (jax.nn.sigmoid(gate_a) * y_a + jax.nn.sigmoid(gate_b) * y_b) @ w_out
    x = x + rmsnorm(mix, g_post_mix)

    hf = jnp.square(jax.nn.relu(rmsnorm(x, g_pre_ffn) @ w_ff1)) @ w_ff2
    x = x + rmsnorm(hf, g_post_ffn)
    return x, kd.reshape(B, T, HB, 2 * DK), vd, C_new, n_new, m_new, conv_new


def setup_inputs(seed: int = 0) -> dict:
    key = jax.random.key(seed)
    ks = jax.random.split(key, 32)
    f32 = jnp.float32

    def nrm(k, shape, s):
        return jax.random.normal(k, shape, f32) * s

    def gain(k, shape):
        return 1.0 + 0.05 * jax.random.normal(k, shape, f32)

    off_f = 4 * D_A + HA
    b_in = nrm(ks[14], (DEPTH, N_IN), 0.02)
    b_in = b_in.at[:, off_f:off_f + HA].add(jnp.linspace(3.0, 6.0, HA, dtype=f32))
    return {
        "x_prompt": nrm(ks[0], (BATCH, SEQ, D_MODEL), 1.0),
        "x_sample": nrm(ks[1], (DEC_BATCH, DEC_SEQ, D_MODEL), 1.0),
        "cache_k": nrm(ks[2], (DEPTH, DEC_BATCH, PAST_LEN, HB, 2 * DK), 1.0),
        "cache_v": nrm(ks[3], (DEPTH, DEC_BATCH, PAST_LEN, HB, DV), 1.0),
        "state_C": nrm(ks[4], (DEPTH, DEC_BATCH, HA, DH, DH), 0.1),
        "state_n": nrm(ks[5], (DEPTH, DEC_BATCH, HA, DH), 0.1),
        "state_m": nrm(ks[6], (DEPTH, DEC_BATCH, HA), 1.0),
        "state_conv": nrm(ks[7], (DEPTH, DEC_BATCH, CONV_W - 1, 2 * D_A), 1.0),
        "rel_bias": nrm(ks[8], (NUM_BUCKETS, HB), 0.5),
        "g_pre_mix": gain(ks[9], (DEPTH, D_MODEL)),
        "g_post_mix": gain(ks[10], (DEPTH, D_MODEL)),
        "g_pre_ffn": gain(ks[11], (DEPTH, D_MODEL)),
        "g_post_ffn": gain(ks[12], (DEPTH, D_MODEL)),
        "w_in": nrm(ks[13], (DEPTH, D_MODEL, N_IN), D_MODEL ** -0.5),
        "b_in": b_in,
        "conv_w": nrm(ks[15], (DEPTH, CONV_W, 2 * D_A), CONV_W ** -0.5),
        "conv_b": nrm(ks[16], (DEPTH, 2 * D_A), 0.02),
        "g_head_a": gain(ks[17], (DEPTH, HA, DH)),
        "w_pa": nrm(ks[18], (DEPTH, D_A, D_MODEL), D_A ** -0.5),
        "lambda_q1": nrm(ks[19], (DEPTH, DK), 0.1),
        "lambda_k1": nrm(ks[20], (DEPTH, DK), 0.1),
        "lambda_q2": nrm(ks[21], (DEPTH, DK), 0.1),
        "lambda_k2": nrm(ks[22], (DEPTH, DK), 0.1),
        "g_head_b": gain(ks[23], (DEPTH, DV)),
        "w_pb": nrm(ks[24], (DEPTH, D_VB, D_MODEL), D_VB ** -0.5),
        "w_out": nrm(ks[25], (DEPTH, D_MODEL, D_MODEL), D_MODEL ** -0.5),
        "w_ff1": nrm(ks[26], (DEPTH, D_MODEL, FF), D_MODEL ** -0.5),
        "w_ff2": nrm(ks[27], (DEPTH, FF, D_MODEL), FF ** -0.5),
    }


def reference(x_prompt, x_sample, cache_k, cache_v, state_C, state_n, state_m, state_conv, rel_bias,
              g_pre_mix, g_post_mix, g_pre_ffn, g_post_ffn, w_in, b_in, conv_w, conv_b, g_head_a, w_pa,
              lambda_q1, lambda_k1, lambda_q2, lambda_k2, g_head_b, w_pb, w_out, w_ff1, w_ff2):
    f32 = jnp.float32
    yp, ys = x_prompt, x_sample
    kp_l, vp_l, Cp_l, np_l, mp_l, cp_l = [], [], [], [], [], []
    ks_l, vs_l, Cs_l, ns_l, ms_l, cs_l = [], [], [], [], [], []
    for l in range(DEPTH):
        lw = (rel_bias, g_pre_mix[l], g_post_mix[l], g_pre_ffn[l], g_post_ffn[l], w_in[l], b_in[l],
              conv_w[l], conv_b[l], g_head_a[l], w_pa[l], lambda_q1[l], lambda_k1[l], lambda_q2[l],
              lambda_k2[l], g_head_b[l], w_pb[l], w_out[l], w_ff1[l], w_ff2[l],
              0.8 - 0.6 * math.exp(-0.3 * l))
        B = yp.shape[0]
        yp, kp, vp, Cp, n_p, mp, cp = trunk_layer(
            yp, jnp.zeros((B, 0, HB, 2 * DK), yp.dtype), jnp.zeros((B, 0, HB, DV), yp.dtype),
            jnp.zeros((B, HA, DH, DH), f32), jnp.zeros((B, HA, DH), f32), jnp.zeros((B, HA), f32),
            jnp.zeros((B, CONV_W - 1, 2 * D_A), yp.dtype), *lw)
        ys, k_s, v_s, C_s, n_s, m_s, c_s = trunk_layer(
            ys, cache_k[l], cache_v[l], state_C[l], state_n[l], state_m[l], state_conv[l], *lw)
        kp_l.append(kp); vp_l.append(vp); Cp_l.append(Cp); np_l.append(n_p); mp_l.append(mp); cp_l.append(cp)
        ks_l.append(k_s); vs_l.append(v_s); Cs_l.append(C_s); ns_l.append(n_s); ms_l.append(m_s); cs_l.append(c_s)
    return (yp, ys,
            jnp.stack(kp_l), jnp.stack(vp_l), jnp.stack(Cp_l), jnp.stack(np_l), jnp.stack(mp_l), jnp.stack(cp_l),
            jnp.stack(ks_l), jnp.stack(vs_l), jnp.stack(Cs_l), jnp.stack(ns_l), jnp.stack(ms_l), jnp.stack(cs_l))
```

```cpp
#include <hip/hip_runtime.h>
#include <cstdio>
#include <cstdint>
typedef unsigned short bf16_t;
typedef short bf16x8 __attribute__((ext_vector_type(8)));
typedef float f32x4 __attribute__((ext_vector_type(4)));
typedef float f32x2 __attribute__((ext_vector_type(2)));
typedef float f32x16 __attribute__((ext_vector_type(16)));
typedef unsigned u32x4 __attribute__((ext_vector_type(4)));
typedef unsigned u32x2 __attribute__((ext_vector_type(2)));
#define LAS __attribute__((address_space(3)))
#define GAS __attribute__((address_space(1)))

constexpr int D = 1024, SEQ = 16384, TP = 2 * SEQ, DB = 16, DSEQ = 32, TS = DB * DSEQ, PAST = 1024;
constexpr int M = TP + TS;
constexpr int MPAD = 33536;
constexpr int NIN = 5640, NP = 5632, FF = 4096;
constexpr int DH = 128, HA = 4, HB = 4, DK = 64, DV = 128;
constexpr int C_QA = 0, C_KA = 512, C_VA = 1024, C_OA = 1536, C_QB = 2048, C_KB = 2560, C_VB = 3072, C_GA = 3584, C_GB = 4608;
constexpr int KSROWS = 1152;
constexpr float EPS = 1e-6f;
constexpr float LOG2E = 1.4426950408889634f;
constexpr float QSCALE = 0.125f * LOG2E;
constexpr float LAM_INIT = 0.2f;
constexpr int NCHUNK_P = TP / 64;
constexpr int NUNIT_ML = NCHUNK_P * HA + DB * HA;

constexpr size_t O_YP = 0, O_YS = O_YP + (size_t)TP * D, O_KP = O_YS + (size_t)TS * D, O_VP = O_KP + (size_t)TP * 512,
    O_CP = O_VP + (size_t)TP * 512, O_NP = O_CP + 2 * 4 * 128 * 128, O_MP = O_NP + 2 * 4 * 128, O_CVP = O_MP + 8,
    O_KS = O_CVP + 2 * 3 * 1024, O_VS = O_KS + (size_t)TS * 512, O_CS = O_VS + (size_t)TS * 512, O_NS = O_CS + (size_t)DB * 4 * 128 * 128,
    O_MS = O_NS + DB * 4 * 128, O_CVS = O_MS + DB * 4, O_END = O_CVS + DB * 3 * 1024;
static_assert(O_END == 69401672, "d_out size");
constexpr size_t OS_DST = 0;
constexpr size_t OS_KS = (size_t)80 << 20, OS_VS = OS_KS + ((size_t)18 << 20);

constexpr size_t MiB = 1u << 20;
constexpr size_t WS_CTL = 0, CTL_ZERO_BYTES = 1 * MiB;
constexpr size_t WS_MISC = 1 * MiB;
constexpr size_t WS_GATES = 2 * MiB;
constexpr size_t WS_WIN = 4 * MiB, WS_WPA = 15 * MiB, WS_WPB = 16 * MiB, WS_WOUT = 17 * MiB, WS_WFF1 = 19 * MiB, WS_WFF2 = 27 * MiB;
constexpr size_t WS_XN = 35 * MiB;
constexpr size_t WS_PROJ = 100 * MiB;
constexpr size_t WS_XN2 = WS_PROJ, WS_H = WS_PROJ + 65 * MiB;
constexpr size_t WS_ATT = 461 * MiB;
constexpr size_t WS_MLS = 493 * MiB;
constexpr size_t WS_END = 504 * MiB;
static_assert(WS_PROJ + (size_t)MPAD * NP * 2 <= WS_ATT && WS_H + (size_t)M * FF * 2 <= WS_ATT && WS_XN + (size_t)M * D * 2 <= WS_PROJ, "ws map");
constexpr size_t ML_ND = 0;
constexpr size_t ML_SC = ML_ND + (size_t)NUNIT_ML * 128 * 4;
constexpr size_t ML_NST = ML_SC + (size_t)NUNIT_ML * 16;
constexpr size_t ML_MST = ML_NST + (size_t)NUNIT_ML * 128 * 4;
constexpr size_t ML_CSS = 4 * MiB;
constexpr size_t ML_DSS = 6 * MiB;
static_assert(ML_MST + (size_t)NUNIT_ML * 4 <= ML_CSS, "mls map");

__device__ __forceinline__ unsigned f2bf(float f) { unsigned u = __builtin_bit_cast(unsigned, f); return (u + 0x7fffu + ((u >> 16) & 1u)) >> 16; }
__device__ __forceinline__ unsigned pk2(float lo, float hi) { return f2bf(lo) | (f2bf(hi) << 16); }
__device__ __forceinline__ float bf2f(unsigned h) { return __builtin_bit_cast(float, h << 16); }
__device__ __forceinline__ float bflo(unsigned w) { return __builtin_bit_cast(float, w << 16); }
__device__ __forceinline__ float bfhi(unsigned w) { return __builtin_bit_cast(float, w & 0xffff0000u); }
__device__ __forceinline__ float sigmoidf_(float x) { return 1.0f / (1.0f + __expf(-x)); }
__device__ __forceinline__ float wave_sum(float v) {
#pragma unroll
    for (int o = 1; o < 64; o <<= 1) v += __shfl_xor(v, o);
    return v;
}
__device__ __forceinline__ int crow(int r, int hi) { return (r & 3) + 8 * (r >> 2) + 4 * hi; }

struct Ptrs {
    const float* in[28]; float* out; unsigned char* ws;
};
enum { I_XP = 0, I_XS, I_CK, I_CV, I_SC, I_SN, I_SM, I_SCONV, I_RELB, I_GPRE, I_GPOST, I_GPREF, I_GPOSTF, I_WIN, I_BIN, I_CONVW, I_CONVB, I_GHA, I_WPA,
       I_LQ1, I_LK1, I_LQ2, I_LK2, I_GHB, I_WPB, I_WOUT, I_WFF1, I_WFF2 };
__device__ __forceinline__ void p0_transpose_item(const float* W, int ldw, int K, int src_col0, bf16_t* WT, int dst_row0, int ncols, LAS float* scr, int item, int lane) {
    const int nblk = ncols / 32, kb = item / nblk, nb = item % nblk, k0 = 64 * kb, n0 = 32 * nb;
#pragma unroll 8
    for (int i = 0; i < 32; ++i) { const int kk = 2 * i + (lane >> 5); scr[kk * 33 + (lane & 31)] = W[(size_t)(k0 + kk) * ldw + src_col0 + n0 + (lane & 31)]; }
    asm volatile("s_waitcnt lgkmcnt(0)" ::: "memory");
    const int c = lane & 7;
#pragma unroll
    for (int j = 0; j < 4; ++j) { const int n = (lane >> 3) + 8 * j; const LAS float* s = scr + (8 * c) * 33 + n;
        u32x4 o; o.x = pk2(s[0 * 33], s[1 * 33]); o.y = pk2(s[2 * 33], s[3 * 33]); o.z = pk2(s[4 * 33], s[5 * 33]); o.w = pk2(s[6 * 33], s[7 * 33]);
        *(u32x4*)(WT + (size_t)(dst_row0 + n0 + n) * K + k0 + 8 * c) = o; }
    asm volatile("s_waitcnt lgkmcnt(0)" ::: "memory");
}
__device__ __forceinline__ int t5_bucket(int delta) {
    const int n = delta < 0 ? -delta : delta; int b;
    if (n < 8) b = n; else b = 8 + (n >= 12) + (n >= 16) + (n >= 23) + (n >= 32) + (n >= 46) + (n >= 64) + (n >= 91);
    return (delta > 0 ? 16 : 0) + b;
}
__device__ __forceinline__ void p0_prologue(const Ptrs& P, LAS unsigned char* lds, int gw, int NGW, int wave, int lane, int tid, int bid, int nblk_total) {
    unsigned char* ws = P.ws;
    LAS float* wg = (LAS float*)(lds + 8 * 8448);
    for (int k = tid; k < 1024; k += 512) { const f32x4 a = *(const f32x4*)(P.in[I_WIN] + (size_t)k * NIN + 2048), b = *(const f32x4*)(P.in[I_WIN] + (size_t)k * NIN + 2052);
        wg[0 * 1024 + k] = a.x; wg[1 * 1024 + k] = a.y; wg[2 * 1024 + k] = a.z; wg[3 * 1024 + k] = a.w; wg[4 * 1024 + k] = b.x; wg[5 * 1024 + k] = b.y; wg[6 * 1024 + k] = b.z; wg[7 * 1024 + k] = b.w; }
    __syncthreads();
    LAS float* scr = (LAS float*)(lds + wave * 8448);
    bf16_t* win_t = (bf16_t*)(ws + WS_WIN); bf16_t* wpa_t = (bf16_t*)(ws + WS_WPA); bf16_t* wpb_t = (bf16_t*)(ws + WS_WPB);
    bf16_t* wout_t = (bf16_t*)(ws + WS_WOUT); bf16_t* wff1_t = (bf16_t*)(ws + WS_WFF1); bf16_t* wff2_t = (bf16_t*)(ws + WS_WFF2);
    constexpr int I_A = 16 * 64, I_B = 16 * 112, I_PA = 8 * 32, I_PB = 8 * 32, I_O = 16 * 32, I_1 = 16 * 128, I_2 = 64 * 32;
    constexpr int NITEMS = I_A + I_B + I_PA + I_PB + I_O + I_1 + I_2;
    for (int it = gw; it < NITEMS; it += NGW) {
        int r = it;
        if (r < I_A) { p0_transpose_item(P.in[I_WIN], NIN, 1024, 0, win_t, 0, 2048, scr, r, lane); continue; } r -= I_A;
        if (r < I_B) { p0_transpose_item(P.in[I_WIN], NIN, 1024, 2056, win_t, 2048, 3584, scr, r, lane); continue; } r -= I_B;
        if (r < I_PA) { p0_transpose_item(P.in[I_WPA], 1024, 512, 0, wpa_t, 0, 1024, scr, r, lane); continue; } r -= I_PA;
        if (r < I_PB) { p0_transpose_item(P.in[I_WPB], 1024, 512, 0, wpb_t, 0, 1024, scr, r, lane); continue; } r -= I_PB;
        if (r < I_O) { p0_transpose_item(P.in[I_WOUT], 1024, 1024, 0, wout_t, 0, 1024, scr, r, lane); continue; } r -= I_O;
        if (r < I_1) { p0_transpose_item(P.in[I_WFF1], 4096, 1024, 0, wff1_t, 0, 4096, scr, r, lane); continue; } r -= I_1;
        p0_transpose_item(P.in[I_WFF2], 1024, 4096, 0, wff2_t, 0, 1024, scr, r, lane);
    }
    bf16_t* XN = (bf16_t*)(ws + WS_XN); float* GT = (float*)(ws + WS_GATES);
    const float* gpre = P.in[I_GPRE]; const float* bin = P.in[I_BIN];
    f32x4 gv[4];
#pragma unroll
    for (int j = 0; j < 4; ++j) gv[j] = *((const f32x4*)gpre + lane + 64 * j);
    for (int m = gw; m < M; m += NGW) {
        const float* xrow = (m < TP) ? P.in[I_XP] + (size_t)m * D : P.in[I_XS] + (size_t)(m - TP) * D;
        f32x4 v[4]; float s = 0.f;
#pragma unroll
        for (int j = 0; j < 4; ++j) { v[j] = *((const f32x4*)xrow + lane + 64 * j); s += (v[j].x * v[j].x + v[j].y * v[j].y) + (v[j].z * v[j].z + v[j].w * v[j].w); }
        const float rstd = 1.0f / sqrtf(wave_sum(s) * (1.f / D) + EPS);
#pragma unroll
        for (int j = 0; j < 4; ++j) v[j] = v[j] * rstd * gv[j];
        unsigned long long* o8 = (unsigned long long*)(XN + (size_t)m * D) + lane;
#pragma unroll
        for (int j = 0; j < 4; ++j) o8[64 * j] = (unsigned long long)pk2(v[j].x, v[j].y) | ((unsigned long long)pk2(v[j].z, v[j].w) << 32);
        float g8[8];
#pragma unroll
        for (int q = 0; q < 8; ++q) { float a = 0.f;
#pragma unroll
            for (int j = 0; j < 4; ++j) { const f32x4 w = *((const LAS f32x4*)(wg + q * 1024) + lane + 64 * j); a += (v[j].x * w.x + v[j].y * w.y) + (v[j].z * w.z + v[j].w * w.w); }
            g8[q] = wave_sum(a); }
        if (lane < 8) { float val = g8[0];
#pragma unroll
            for (int q = 1; q < 8; ++q) val = (lane == q) ? g8[q] : val;
            GT[(size_t)m * 8 + lane] = val + bin[2048 + lane]; }
    }
    const size_t gt = (size_t)bid * 512 + tid, NT = (size_t)nblk_total * 512;
    {
        bf16_t* KS = (bf16_t*)((unsigned char*)P.out + OS_KS); bf16_t* VS = (bf16_t*)((unsigned char*)P.out + OS_VS);
        const size_t n8 = (size_t)DB * KSROWS * 64;
        for (size_t i = gt; i < 2 * n8; i += NT) {
            const int which = i >= n8; const size_t j = which ? i - n8 : i; const int c8 = (int)(j & 63); const int p = (int)((j >> 6) % KSROWS); const int b = (int)((j >> 6) / KSROWS);
            bf16_t* dst = (which ? VS : KS) + ((size_t)b * KSROWS + p) * 512 + c8 * 8;
            if (p < PAST) { const float* src = (which ? P.in[I_CV] : P.in[I_CK]) + ((size_t)b * PAST + p) * 512 + c8 * 8; const f32x4 a = *(const f32x4*)src, c = *(const f32x4*)(src + 4);
                u32x4 o; o.x = pk2(a.x, a.y); o.y = pk2(a.z, a.w); o.z = pk2(c.x, c.y); o.w = pk2(c.z, c.w); *(u32x4*)dst = o; }
            else if (p >= PAST + DSEQ) { *(u32x4*)dst = (u32x4){0u, 0u, 0u, 0u}; }
        }
    }
    {
        bf16_t* CSS = (bf16_t*)(ws + WS_MLS + ML_CSS); const float* sc = P.in[I_SC];
        for (size_t i = gt; i < (size_t)DB * 4 * 128 * 128 / 8; i += NT) { const f32x4 a = *(const f32x4*)(sc + i * 8), c = *(const f32x4*)(sc + i * 8 + 4);
            u32x4 o; o.x = pk2(a.x, a.y); o.y = pk2(a.z, a.w); o.z = pk2(c.x, c.y); o.w = pk2(c.z, c.w); *(u32x4*)(CSS + i * 8) = o; }
    }
    {
        u32x4* pz = (u32x4*)((bf16_t*)(ws + WS_PROJ) + (size_t)M * NP);
        for (size_t i = gt; i < (size_t)(MPAD - M) * NP / 8; i += NT) pz[i] = (u32x4){0u, 0u, 0u, 0u};
        float* gz = GT + (size_t)M * 8;
        for (size_t i = gt; i < (size_t)(MPAD - M) * 8; i += NT) gz[i] = 0.f;
    }
    if (bid == 0) {
        float* TBL = (float*)(ws + WS_MISC); const float* rb = P.in[I_RELB];
        for (int i = tid; i < 4096; i += 512) { const int h = i >> 10, delta = (i & 1023) - 512; TBL[i] = (rb[t5_bucket(delta) * 4 + h] - rb[15 * 4 + h]) * LOG2E; }
        if (wave == 0) {
            const float a = wave_sum(P.in[I_LQ1][lane] * P.in[I_LK1][lane]), b = wave_sum(P.in[I_LQ2][lane] * P.in[I_LK2][lane]);
            if (lane == 0) ((float*)(ws + WS_MISC + 16384))[0] = expf(a) - expf(b) + LAM_INIT;
        }
    }
}
template <class Epi>
__global__ void __launch_bounds__(256) simple_gemm(const bf16_t* A, int lda, const bf16_t* Bt, int K, int nbn, Epi E) {
    const int tid = threadIdx.x, lane = tid & 63, wid = tid >> 6, r32 = lane & 31, hi = lane >> 5;
    const int bm = blockIdx.x / nbn, bn = blockIdx.x % nbn;
    const int row0 = bm * 128 + (wid >> 1) * 64, col0 = bn * 128 + (wid & 1) * 64;
    f32x16 acc[2][2];
#pragma unroll
    for (int i = 0; i < 2; ++i)
#pragma unroll
        for (int j = 0; j < 2; ++j)
#pragma unroll
            for (int r = 0; r < 16; ++r) acc[i][j][r] = 0.f;
    const bf16_t* a0 = A + (size_t)(row0 + r32) * lda + 8 * hi; const bf16_t* a1 = a0 + (size_t)32 * lda;
    const bf16_t* b0 = Bt + (size_t)(col0 + r32) * K + 8 * hi; const bf16_t* b1 = b0 + (size_t)32 * K;
    for (int k0 = 0; k0 < K; k0 += 16) {
        const bf16x8 fa0 = *(const bf16x8*)(a0 + k0), fa1 = *(const bf16x8*)(a1 + k0), fb0 = *(const bf16x8*)(b0 + k0), fb1 = *(const bf16x8*)(b1 + k0);
        acc[0][0] = __builtin_amdgcn_mfma_f32_32x32x16_bf16(fa0, fb0, acc[0][0], 0, 0, 0);
        acc[0][1] = __builtin_amdgcn_mfma_f32_32x32x16_bf16(fa0, fb1, acc[0][1], 0, 0, 0);
        acc[1][0] = __builtin_amdgcn_mfma_f32_32x32x16_bf16(fa1, fb0, acc[1][0], 0, 0, 0);
        acc[1][1] = __builtin_amdgcn_mfma_f32_32x32x16_bf16(fa1, fb1, acc[1][1], 0, 0, 0);
    }
#pragma unroll
    for (int i = 0; i < 2; ++i)
#pragma unroll
        for (int j = 0; j < 2; ++j)
#pragma unroll
            for (int r = 0; r < 16; ++r) E(row0 + 32 * i + crow(r, hi), col0 + 32 * j + r32, acc[i][j][r]);
}
struct SEpiInproj {
    Ptrs P;
    __device__ __forceinline__ void operator()(int row, int p, float acc) const {
        bf16_t* PROJ = (bf16_t*)(P.ws + WS_PROJ); float* out = P.out;
        const int orig = p < 2048 ? p : p + 8; float v = acc + P.in[I_BIN][orig]; float st = v;
        if (p < C_VA) {
            if (row < TP) { const int t = row & (SEQ - 1); if (t >= SEQ - 3) out[O_CVP + ((size_t)(row >> 14) * 3 + (t - (SEQ - 3))) * 1024 + p] = v; }
            else { const int rs = row - TP, t = rs & 31; if (t >= 29) out[O_CVS + ((size_t)(rs >> 5) * 3 + (t - 29)) * 1024 + p] = v; }
        } else if (p < C_OA) {
        } else if (p < C_QB) { st = sigmoidf_(v);
        } else if (p < C_KB) { st = v * QSCALE;
        } else if (p < C_GA) {
            const int isv = p >= C_VB, c = p - (isv ? C_VB : C_KB);
            if (row < TP) out[(isv ? O_VP : O_KP) + (size_t)row * 512 + c] = v;
            else { const int rs = row - TP; out[(isv ? O_VS : O_KS) + (size_t)rs * 512 + c] = v;
                bf16_t* KV = (bf16_t*)((unsigned char*)P.out + (isv ? OS_VS : OS_KS)); KV[((size_t)(rs >> 5) * KSROWS + PAST + (rs & 31)) * 512 + c] = (bf16_t)f2bf(v); }
        } else { st = sigmoidf_(v); }
        PROJ[(size_t)row * NP + p] = (bf16_t)f2bf(st);
    }
};
struct SEpiMerge1 { Ptrs P; __device__ __forceinline__ void operator()(int row, int c, float acc) const {
    const bf16_t* PROJ = (const bf16_t*)(P.ws + WS_PROJ); bf16_t* MG = (bf16_t*)(P.ws + WS_XN);
    MG[(size_t)row * D + c] = (bf16_t)f2bf(acc * bf2f(PROJ[(size_t)row * NP + C_GA + c])); } };
struct SEpiMerge2 { Ptrs P; __device__ __forceinline__ void operator()(int row, int c, float acc) const {
    const bf16_t* PROJ = (const bf16_t*)(P.ws + WS_PROJ); bf16_t* MG = (bf16_t*)(P.ws + WS_XN);
    MG[(size_t)row * D + c] = (bf16_t)f2bf(bf2f(MG[(size_t)row * D + c]) + acc * bf2f(PROJ[(size_t)row * NP + C_GB + c])); } };
struct SEpiF32 { float* O; int ldc; __device__ __forceinline__ void operator()(int row, int c, float acc) const { O[(size_t)row * ldc + c] = acc; } };
struct SEpiBf { bf16_t* O; int ldc; __device__ __forceinline__ void operator()(int row, int c, float acc) const { O[(size_t)row * ldc + c] = (bf16_t)f2bf(acc); } };
struct SEpiRelu2 { bf16_t* O; int ldc; __device__ __forceinline__ void operator()(int row, int c, float acc) const { const float r = acc > 0.f ? acc : 0.f; O[(size_t)row * ldc + c] = (bf16_t)f2bf(r * r); } };

__global__ void __launch_bounds__(256) base_norm1(Ptrs P) {
    const int lane = threadIdx.x & 63, m = blockIdx.x * 4 + (threadIdx.x >> 6); if (m >= M) return;
    float* y = P.out + (size_t)m * D; const float* xr = (m < TP) ? P.in[I_XP] + (size_t)m * D : P.in[I_XS] + (size_t)(m - TP) * D;
    bf16_t* XN2 = (bf16_t*)(P.ws + WS_XN2) + (size_t)m * D;
    f32x4 v[4]; float s = 0.f;
#pragma unroll
    for (int j = 0; j < 4; ++j) { v[j] = *((const f32x4*)y + lane + 64 * j); s += (v[j].x * v[j].x + v[j].y * v[j].y) + (v[j].z * v[j].z + v[j].w * v[j].w); }
    const float rstd = 1.0f / sqrtf(wave_sum(s) * (1.f / D) + EPS); float s2 = 0.f;
#pragma unroll
    for (int j = 0; j < 4; ++j) { const f32x4 g = *((const f32x4*)P.in[I_GPOST] + lane + 64 * j), x = *((const f32x4*)xr + lane + 64 * j); v[j] = x + v[j] * rstd * g;
        *((f32x4*)y + lane + 64 * j) = v[j]; s2 += (v[j].x * v[j].x + v[j].y * v[j].y) + (v[j].z * v[j].z + v[j].w * v[j].w); }
    const float rstd2 = 1.0f / sqrtf(wave_sum(s2) * (1.f / D) + EPS);
#pragma unroll
    for (int j = 0; j < 4; ++j) { const f32x4 g = *((const f32x4*)P.in[I_GPREF] + lane + 64 * j); const f32x4 o = v[j] * rstd2 * g;
        ((unsigned long long*)XN2)[lane + 64 * j] = (unsigned long long)pk2(o.x, o.y) | ((unsigned long long)pk2(o.z, o.w) << 32); }
}
__global__ void __launch_bounds__(256) base_norm2(Ptrs P) {
    const int lane = threadIdx.x & 63, m = blockIdx.x * 4 + (threadIdx.x >> 6); if (m >= M) return;
    float* y = P.out + (size_t)m * D; const bf16_t* hf = (const bf16_t*)(P.ws + WS_XN) + (size_t)m * D;
    f32x4 v[4]; float s = 0.f;
#pragma unroll
    for (int j = 0; j < 4; ++j) { const u32x2 w = *((const u32x2*)hf + lane + 64 * j); v[j] = (f32x4){bflo(w.x), bfhi(w.x), bflo(w.y), bfhi(w.y)}; s += (v[j].x * v[j].x + v[j].y * v[j].y) + (v[j].z * v[j].z + v[j].w * v[j].w); }
    const float rstd = 1.0f / sqrtf(wave_sum(s) * (1.f / D) + EPS);
#pragma unroll
    for (int j = 0; j < 4; ++j) { const f32x4 g = *((const f32x4*)P.in[I_GPOSTF] + lane + 64 * j), x = *((const f32x4*)y + lane + 64 * j); *((f32x4*)y + lane + 64 * j) = x + v[j] * rstd * g; }
}
__global__ void __launch_bounds__(512) base_attn(Ptrs P) {
    __shared__ float KV[2 * 32 * 128]; __shared__ float tb[1024]; __shared__ float red[64 * 4];
    float* Ks = KV; float* Vs = KV + 32 * 128;
    const int tid = threadIdx.x, qi = tid & 63, w = tid >> 6, c = w & 1, vq = w >> 1;
    const bf16_t* PROJ = (const bf16_t*)(P.ws + WS_PROJ);
    int u = blockIdx.x, h, nq, nk, kvpitch; long qrow0; int qpos0; const bf16_t *Kp, *Vp;
    if (u < 2048) { const int b = u >> 10, qc = u & 255; h = (u >> 8) & 3; nq = 64; nk = 64 * (qc + 1); qrow0 = (long)b * SEQ + qc * 64; qpos0 = qc * 64; kvpitch = NP;
        Kp = PROJ + (size_t)b * SEQ * NP + C_KB + h * 128; Vp = PROJ + (size_t)b * SEQ * NP + C_VB + h * 128; }
    else { const int v = u - 2048, b = v >> 2; h = v & 3; nq = 32; nk = PAST + DSEQ; qrow0 = TP + b * 32; qpos0 = PAST; kvpitch = 512;
        Kp = (const bf16_t*)((const unsigned char*)P.out + OS_KS) + (size_t)b * KSROWS * 512 + h * 128; Vp = (const bf16_t*)((const unsigned char*)P.out + OS_VS) + (size_t)b * KSROWS * 512 + h * 128; }
    for (int i = tid; i < 1024; i += 512) tb[i] = ((const float*)(P.ws + WS_MISC))[h * 1024 + i];
    const float lam = ((const float*)(P.ws + WS_MISC + 16384))[0];
    const bool valid = qi < nq; const long qrow = qrow0 + (valid ? qi : 0); const int qpos = qpos0 + (valid ? qi : 0);
    float q[64];
    { const bf16_t* qp = PROJ + (size_t)qrow * NP + C_QB + h * 128 + c * 64;
#pragma unroll
      for (int d = 0; d < 64; d += 2) { const unsigned w1 = *(const unsigned*)(qp + d); q[d] = bflo(w1); q[d + 1] = bfhi(w1); } }
    float o[32], m1 = -1e30f, l1 = 0.f;
#pragma unroll
    for (int i = 0; i < 32; ++i) o[i] = 0.f;
    for (int k0 = 0; k0 < nk; k0 += 32) {
        __syncthreads();
        { const int i = tid; const int j = i >> 4, c8 = (i & 15) * 8; const bool in = (k0 + j) < nk;
            u32x4 kw = (u32x4){0u, 0u, 0u, 0u}, vw = kw;
            if (in) { kw = *(const u32x4*)(Kp + (size_t)(k0 + j) * kvpitch + c8); vw = *(const u32x4*)(Vp + (size_t)(k0 + j) * kvpitch + c8); }
            float* kd = Ks + j * 128 + c8; float* vd = Vs + j * 128 + c8;
            kd[0] = bflo(kw.x); kd[1] = bfhi(kw.x); kd[2] = bflo(kw.y); kd[3] = bfhi(kw.y); kd[4] = bflo(kw.z); kd[5] = bfhi(kw.z); kd[6] = bflo(kw.w); kd[7] = bfhi(kw.w);
            vd[0] = bflo(vw.x); vd[1] = bfhi(vw.x); vd[2] = bflo(vw.y); vd[3] = bfhi(vw.y); vd[4] = bflo(vw.z); vd[5] = bfhi(vw.z); vd[6] = bflo(vw.w); vd[7] = bfhi(vw.w); }
        __syncthreads();
        const int jn = (nk - k0) < 32 ? (nk - k0) : 32;
        for (int j = 0; j < jn; ++j) {
            const float* kr = Ks + j * 128 + c * 64; float s1 = 0.f;
#pragma unroll
            for (int d = 0; d < 64; ++d) s1 += q[d] * kr[d];
            { int dl = (k0 + j) - qpos; dl = dl < -512 ? -512 : dl; s1 += tb[dl + 512]; }
            const float* vr = Vs + j * 128 + vq * 32;
            const float mn = fmaxf(m1, s1), cc = exp2f(m1 - mn), p = exp2f(s1 - mn); m1 = mn; l1 = l1 * cc + p;
#pragma unroll
            for (int i = 0; i < 32; ++i) o[i] = o[i] * cc + p * vr[i];
        }
    }
    __syncthreads();
    const float rl = (c == 1 ? lam : 1.0f) / l1;
#pragma unroll
    for (int i = 0; i < 32; ++i) o[i] *= rl;
    if (c == 1) {
#pragma unroll
        for (int i = 0; i < 32; ++i) KV[qi * 128 + vq * 32 + i] = o[i]; }
    __syncthreads();
    float ss = 0.f;
    if (c == 0) {
#pragma unroll
        for (int i = 0; i < 32; ++i) { o[i] -= KV[qi * 128 + vq * 32 + i]; ss += o[i] * o[i]; }
        red[qi * 4 + vq] = ss; }
    __syncthreads();
    if (c == 0 && valid) {
        const float tot = (red[qi * 4 + 0] + red[qi * 4 + 1]) + (red[qi * 4 + 2] + red[qi * 4 + 3]);
        const float rstd = (1.0f / sqrtf(tot * (1.f / 128.f) + EPS)) * (1.0f - LAM_INIT);
        bf16_t* ob = (bf16_t*)(P.ws + WS_PROJ) + (size_t)qrow * NP + C_QB + h * 128 + vq * 32; const float* g = P.in[I_GHB] + vq * 32;
#pragma unroll
        for (int i = 0; i < 32; i += 8) { u32x4 w0;
            w0.x = pk2(o[i] * rstd * g[i], o[i + 1] * rstd * g[i + 1]); w0.y = pk2(o[i + 2] * rstd * g[i + 2], o[i + 3] * rstd * g[i + 3]);
            w0.z = pk2(o[i + 4] * rstd * g[i + 4], o[i + 5] * rstd * g[i + 5]); w0.w = pk2(o[i + 6] * rstd * g[i + 6], o[i + 7] * rstd * g[i + 7]);
            *(u32x4*)(ob + i) = w0; }
    }
}

__device__ __forceinline__ float logsigmoidf_(float x) { return fminf(x, 0.f) - log1pf(expf(-fabsf(x))); }
__device__ __forceinline__ float siluf_(float x) { return x / (1.0f + expf(-x)); }

__global__ void __launch_bounds__(64) base_mlstm(Ptrs P) {
    __shared__ float qs[128], ks[128];
    const int lane = threadIdx.x; int u = blockIdx.x;
    const bool samp = u >= 128; int b, h, rb, T; long row0;
    if (!samp) { b = u >> 6; h = (u >> 4) & 3; rb = u & 15; T = SEQ; row0 = (long)b * SEQ; }
    else { const int v = u - 128; b = v >> 6; h = (v >> 4) & 3; rb = v & 15; T = DSEQ; row0 = TP + b * DSEQ; }
    const int r = lane >> 3, dseg = lane & 7, vv = rb * 8 + r, d0 = dseg * 16;
    const bf16_t* PROJ = (const bf16_t*)(P.ws + WS_PROJ); const float* GT = (const float*)(P.ws + WS_GATES);
    float* hraw = (float*)((unsigned char*)P.out + OS_DST);
    float C[16], n[16], m = 0.f;
#pragma unroll
    for (int i = 0; i < 16; ++i) { C[i] = 0.f; n[i] = 0.f; }
    const int cq = h * 128 + 2 * lane, ck = 512 + h * 128 + 2 * lane;
    float wq[4][2], wk[4][2], bq[2], bk[2], hq[3][2], hk[3][2];
#pragma unroll
    for (int j = 0; j < 4; ++j) { wq[j][0] = P.in[I_CONVW][j * 1024 + cq]; wq[j][1] = P.in[I_CONVW][j * 1024 + cq + 1]; wk[j][0] = P.in[I_CONVW][j * 1024 + ck]; wk[j][1] = P.in[I_CONVW][j * 1024 + ck + 1]; }
    bq[0] = P.in[I_CONVB][cq]; bq[1] = P.in[I_CONVB][cq + 1]; bk[0] = P.in[I_CONVB][ck]; bk[1] = P.in[I_CONVB][ck + 1];
#pragma unroll
    for (int j = 0; j < 3; ++j) { hq[j][0] = hq[j][1] = hk[j][0] = hk[j][1] = 0.f; }
    if (samp) {
        const float* sc = P.in[I_SC] + (((size_t)b * 4 + h) * 128 + vv) * 128 + d0; const float* sn = P.in[I_SN] + ((size_t)b * 4 + h) * 128 + d0;
#pragma unroll
        for (int i = 0; i < 16; ++i) { C[i] = sc[i]; n[i] = sn[i]; }
        m = P.in[I_SM][b * 4 + h];
#pragma unroll
        for (int j = 0; j < 3; ++j) { const float* cv = P.in[I_SCONV] + ((size_t)b * 3 + j) * 1024; hq[j][0] = cv[cq]; hq[j][1] = cv[cq + 1]; hk[j][0] = cv[ck]; hk[j][1] = cv[ck + 1]; }
    }
    for (int t = 0; t < T; ++t) {
        const size_t row = (size_t)(row0 + t); const bf16_t* pr = PROJ + row * NP;
        const unsigned wqr = *(const unsigned*)(pr + C_QA + h * 128 + 2 * lane), wkr = *(const unsigned*)(pr + C_KA + h * 128 + 2 * lane);
        const float xq0 = bflo(wqr), xq1 = bfhi(wqr), xk0 = bflo(wkr), xk1 = bfhi(wkr);
        const float yq0 = bq[0] + wq[0][0] * hq[0][0] + wq[1][0] * hq[1][0] + wq[2][0] * hq[2][0] + wq[3][0] * xq0;
        const float yq1 = bq[1] + wq[0][1] * hq[0][1] + wq[1][1] * hq[1][1] + wq[2][1] * hq[2][1] + wq[3][1] * xq1;
        const float yk0 = bk[0] + wk[0][0] * hk[0][0] + wk[1][0] * hk[1][0] + wk[2][0] * hk[2][0] + wk[3][0] * xk0;
        const float yk1 = bk[1] + wk[0][1] * hk[0][1] + wk[1][1] * hk[1][1] + wk[2][1] * hk[2][1] + wk[3][1] * xk1;
        hq[0][0] = hq[1][0]; hq[1][0] = hq[2][0]; hq[2][0] = xq0; hq[0][1] = hq[1][1]; hq[1][1] = hq[2][1]; hq[2][1] = xq1;
        hk[0][0] = hk[1][0]; hk[1][0] = hk[2][0]; hk[2][0] = xk0; hk[0][1] = hk[1][1]; hk[1][1] = hk[2][1]; hk[2][1] = xk1;
        __syncthreads();
        qs[2 * lane] = siluf_(yq0); qs[2 * lane + 1] = siluf_(yq1); ks[2 * lane] = siluf_(yk0) * 0.08838834764831845f; ks[2 * lane + 1] = siluf_(yk1) * 0.08838834764831845f;
        __syncthreads();
        const float vt = bf2f(pr[C_VA + h * 128 + vv]);
        const float ig = GT[row * 8 + h], lf = logsigmoidf_(GT[row * 8 + 4 + h]);
        const float mn = fmaxf(lf + m, ig), fd = expf(lf + m - mn), iw = expf(ig - mn);
        float num = 0.f, den = 0.f;
#pragma unroll
        for (int i = 0; i < 16; ++i) { const float kk = ks[d0 + i], qq = qs[d0 + i]; C[i] = fd * C[i] + iw * vt * kk; n[i] = fd * n[i] + iw * kk; num += C[i] * qq; den += n[i] * qq; }
        num += __shfl_xor(num, 1); num += __shfl_xor(num, 2); num += __shfl_xor(num, 4);
        den += __shfl_xor(den, 1); den += __shfl_xor(den, 2); den += __shfl_xor(den, 4);
        m = mn;
        if (dseg == 0) hraw[row * 512 + h * 128 + vv] = num / fmaxf(fabsf(den), expf(-mn));
    }
    float* Co = P.out + (samp ? O_CS : O_CP) + (((size_t)b * 4 + h) * 128 + vv) * 128 + d0;
#pragma unroll
    for (int i = 0; i < 16; ++i) Co[i] = C[i];
    if (rb == 0 && r == 0) { float* no = P.out + (samp ? O_NS : O_NP) + ((size_t)b * 4 + h) * 128 + d0;
#pragma unroll
        for (int i = 0; i < 16; ++i) no[i] = n[i];
        if (lane == 0) P.out[(samp ? O_MS : O_MP) + b * 4 + h] = m; }
}
__global__ void __launch_bounds__(256) base_hnorm(Ptrs P) {
    const int lane = threadIdx.x & 63, m = blockIdx.x * 4 + (threadIdx.x >> 6); if (m >= M) return;
    const float* hr = (const float*)((const unsigned char*)P.out + OS_DST) + (size_t)m * 512 + lane * 8;
    bf16_t* pr = (bf16_t*)(P.ws + WS_PROJ) + (size_t)m * NP;
    const f32x4 a = *(const f32x4*)hr, c = *(const f32x4*)(hr + 4);
    float s = (a.x * a.x + a.y * a.y) + (a.z * a.z + a.w * a.w) + (c.x * c.x + c.y * c.y) + (c.z * c.z + c.w * c.w);
    s += __shfl_xor(s, 1); s += __shfl_xor(s, 2); s += __shfl_xor(s, 4); s += __shfl_xor(s, 8);
    const float rstd = 1.0f / sqrtf(s * (1.f / 128.f) + EPS);
    const float* g = P.in[I_GHA] + lane * 8; const u32x4 so = *(const u32x4*)(pr + C_OA + lane * 8);
    u32x4 o; o.x = pk2(a.x * rstd * g[0] * bflo(so.x), a.y * rstd * g[1] * bfhi(so.x)); o.y = pk2(a.z * rstd * g[2] * bflo(so.y), a.w * rstd * g[3] * bfhi(so.y));
    o.z = pk2(c.x * rstd * g[4] * bflo(so.z), c.y * rstd * g[5] * bfhi(so.z)); o.w = pk2(c.z * rstd * g[6] * bflo(so.w), c.w * rstd * g[7] * bfhi(so.w));
    *(u32x4*)(pr + C_VA + lane * 8) = o;
}
__global__ void __launch_bounds__(512) k_p0(Ptrs P) {
    extern __shared__ __attribute__((aligned(16))) unsigned char lds[];
    const int tid = threadIdx.x, lane = tid & 63, wave = __builtin_amdgcn_readfirstlane(tid >> 6);
    p0_prologue(P, (LAS unsigned char*)lds, (int)blockIdx.x * 8 + wave, (int)gridDim.x * 8, wave, lane, tid, (int)blockIdx.x, (int)gridDim.x);
}
extern "C" void kernel_launch(void* const* d_in, const int* in_sizes, int n_in, void* d_out, int out_size, void* d_ws, size_t ws_size, hipStream_t stream) {
    static int ok = 0;
    if (ok == 0) {
        if (n_in != 28 || out_size != (int)O_END || ws_size < WS_END) { fprintf(stderr, "kernel_launch: unexpected shapes: n_in %d out %d ws %zu\n", n_in, out_size, ws_size); ok = -1; return; }
        if (hipFuncSetAttribute((const void*)k_p0, hipFuncAttributeMaxDynamicSharedMemorySize, 100352) != hipSuccess) { fprintf(stderr, "kernel_launch: hipFuncSetAttribute failed\n"); ok = -1; return; }
        ok = 1;
    }
    if (ok < 0) return;
    Ptrs P{};
    for (int i = 0; i < 28; ++i) P.in[i] = (const float*)d_in[i];
    P.out = (float*)d_out; P.ws = (unsigned char*)d_ws;
    unsigned char* ws = (unsigned char*)d_ws;
    bf16_t* PROJ = (bf16_t*)(ws + WS_PROJ);
    k_p0<<<256, 512, 100352, stream>>>(P);
    simple_gemm<SEpiInproj><<<260 * 44, 256, 0, stream>>>((const bf16_t*)(ws + WS_XN), 1024, (const bf16_t*)(ws + WS_WIN), 1024, 44, SEpiInproj{P});
    base_mlstm<<<128 + 1024, 64, 0, stream>>>(P);
    base_hnorm<<<M / 4, 256, 0, stream>>>(P);
    base_attn<<<2048 + 64, 512, 0, stream>>>(P);
    simple_gemm<SEpiMerge1><<<260 * 8, 256, 0, stream>>>(PROJ + C_VA, NP, (const bf16_t*)(ws + WS_WPA), 512, 8, SEpiMerge1{P});
    simple_gemm<SEpiMerge2><<<260 * 8, 256, 0, stream>>>(PROJ + C_QB, NP, (const bf16_t*)(ws + WS_WPB), 512, 8, SEpiMerge2{P});
    simple_gemm<SEpiF32><<<260 * 8, 256, 0, stream>>>((const bf16_t*)(ws + WS_XN), 1024, (const bf16_t*)(ws + WS_WOUT), 1024, 8, SEpiF32{(float*)d_out, 1024});
    base_norm1<<<M / 4, 256, 0, stream>>>(P);
    simple_gemm<SEpiRelu2><<<260 * 32, 256, 0, stream>>>((const bf16_t*)(ws + WS_XN2), 1024, (const bf16_t*)(ws + WS_WFF1), 1024, 32, SEpiRelu2{(bf16_t*)(ws + WS_H), 4096});
    simple_gemm<SEpiBf><<<260 * 8, 256, 0, stream>>>((const bf16_t*)(ws + WS_H), 4096, (const bf16_t*)(ws + WS_WFF2), 4096, 8, SEpiBf{(bf16_t*)(ws + WS_XN), 1024});
    base_norm2<<<M / 4, 256, 0, stream>>>(P);
}
```
